# Optimizing an MI355X kernel written in HIP

```python
import math
import jax, jax.numpy as jnp
from jax import lax
import numpy as np

D_MODEL = 2048
BATCH = 2
SEQ = 4096
DEPTH = 1

N_META = 16
D_ATTN = D_MODEL // 2
D_LRU = D_MODEL // 2
N_HEADS = 8
HEAD_DIM = D_ATTN // (2 * N_HEADS)
V_DIM = 2 * HEAD_DIM
N_LRU_BLOCKS = 8
LRU_BLOCK = D_LRU // N_LRU_BLOCKS
CONV_WIDTH = 4
LRU_C = 8.0
N_BUCKETS = 32
MAX_DISTANCE = 128
Q_BLOCK = 128
NORM_EPS = 1e-6
SUBLN_EPS = 1e-5
D_IN = 4 * D_ATTN + 2 * D_LRU
NEG_INF = -1e30

kernel_name = "hymba_diffattn_rglru_block"


def rmsnorm(x, g, eps):
    xf = x.astype(jnp.float32)
    y = xf * lax.rsqrt(jnp.mean(xf * xf, axis=-1, keepdims=True) + eps)
    return (y * g.astype(jnp.float32)).astype(x.dtype)


def lambda_init_fn(layer_idx):
    return 0.8 - 0.6 * math.exp(-0.3 * layer_idx)


def t5_causal_bucket(dist):
    max_exact = N_BUCKETS // 2
    d = jnp.maximum(dist, 0)
    large = max_exact + (jnp.log(jnp.maximum(d, 1).astype(jnp.float32) / max_exact)
                         / math.log(MAX_DISTANCE / max_exact)
                         * (N_BUCKETS - max_exact)).astype(jnp.int32)
    large = jnp.minimum(large, N_BUCKETS - 1)
    return jnp.where(d < max_exact, d, large)


def diff_attention(q, k, v, dist_bias, lam):
    B, T = q.shape[0], q.shape[1]
    kpos = jnp.arange(T, dtype=jnp.int32)
    scale = HEAD_DIM ** -0.5
    k1, k2 = k[..., 0, :], k[..., 1, :]

    def attend(qb, qpos):
        rel = qpos[:, None] - kpos[None, :]
        bias = jnp.transpose(dist_bias[jnp.clip(rel, 0, T - 1)], (2, 0, 1))
        causal = rel >= 0

        def probs(qh, kh):
            s = jnp.einsum('blhd,bthd->bhlt', qh, kh).astype(jnp.float32) * scale + bias
            s = jnp.where(causal, s, NEG_INF)
            return jax.nn.softmax(s, axis=-1)

        p = probs(qb[..., 0, :], k1) - lam * probs(qb[..., 1, :], k2)
        return jnp.einsum('bhlt,bthe->blhe', p.astype(v.dtype), v)

    out_meta = attend(q[:, :N_META], jnp.arange(N_META, dtype=jnp.int32))
    s_real = T - N_META
    nb = s_real // Q_BLOCK
    qr = jnp.moveaxis(q[:, N_META:].reshape(B, nb, Q_BLOCK, N_HEADS, 2, HEAD_DIM), 1, 0)
    pos = (N_META + jnp.arange(s_real, dtype=jnp.int32)).reshape(nb, Q_BLOCK)
    out_real = lax.map(lambda a: attend(a[0], a[1]), (qr, pos))
    out_real = jnp.moveaxis(out_real, 0, 1).reshape(B, s_real, N_HEADS, V_DIM)
    return jnp.concatenate([out_meta, out_real], axis=1)


def rg_lru_branch(u, conv_w, conv_b, w_a, b_a, w_x, b_x, lru_lambda):
    B, T, C = u.shape
    u = lax.conv_general_dilated(u, conv_w[:, None, :], window_strides=(1,),
                                 padding=[(CONV_WIDTH - 1, 0)],
                                 dimension_numbers=('NWC', 'WIO', 'NWC'),
                                 feature_group_count=C) + conv_b
    ub = u.reshape(B, T, N_LRU_BLOCKS, LRU_BLOCK)
    r = jax.nn.sigmoid((jnp.einsum('btnc,ncd->btnd', ub, w_a).reshape(B, T, C) + b_a).astype(jnp.float32))
    i = jax.nn.sigmoid((jnp.einsum('btnc,ncd->btnd', ub, w_x).reshape(B, T, C) + b_x).astype(jnp.float32))
    log_a = -LRU_C * r * jax.nn.softplus(-lru_lambda.astype(jnp.float32))
    a = jnp.exp(log_a)
    mult = jnp.sqrt(-jnp.expm1(2.0 * log_a))
    mult = jnp.where(jnp.arange(T)[None, :, None] == 0, 1.0, mult)
    b = mult * i * u.astype(jnp.float32)

    def combine(c1, c2):
        a1, b1 = c1
        a2, b2 = c2
        return a1 * a2, a2 * b1 + b2

    _, h = lax.associative_scan(combine, (a, b), axis=1)
    return h.astype(u.dtype)


def setup_inputs(seed: int = 0) -> dict:
    key = jax.random.key(seed)
    ks = jax.random.split(key, 20)
    f32 = jnp.float32
    a0 = jax.random.uniform(ks[10], (DEPTH, D_LRU), f32, 0.9, 0.999)
    s0 = a0 ** (1.0 / LRU_C)
    return {
        "x": jax.random.normal(ks[0], (BATCH, SEQ, D_MODEL), f32),
        "meta_tokens": jax.random.normal(ks[1], (N_META, D_MODEL), f32),
        "rel_bias": 0.2 * jax.random.normal(ks[2], (N_BUCKETS, N_HEADS), f32),
        "norm_g": 1.0 + 0.02 * jax.random.normal(ks[3], (DEPTH, D_MODEL), f32),
        "w_in": jax.random.normal(ks[4], (DEPTH, D_MODEL, D_IN), f32) * D_MODEL ** -0.5,
        "conv_w": jax.random.normal(ks[5], (DEPTH, CONV_WIDTH, D_LRU), f32) * CONV_WIDTH ** -0.5,
        "conv_b": 0.01 * jax.random.normal(ks[6], (DEPTH, D_LRU), f32),
        "w_a": jax.random.normal(ks[7], (DEPTH, N_LRU_BLOCKS, LRU_BLOCK, LRU_BLOCK), f32) * LRU_BLOCK ** -0.5,
        "b_a": 0.01 * jax.random.normal(ks[8], (DEPTH, D_LRU), f32),
        "w_x": jax.random.normal(ks[9], (DEPTH, N_LRU_BLOCKS, LRU_BLOCK, LRU_BLOCK), f32) * LRU_BLOCK ** -0.5,
        "b_x": 0.01 * jax.random.normal(ks[11], (DEPTH, D_LRU), f32),
        "lru_lambda": jnp.log(s0 / (1.0 - s0)),
        "lam_q1": 0.1 * jax.random.normal(ks[12], (DEPTH, HEAD_DIM), f32),
        "lam_k1": 0.1 * jax.random.normal(ks[13], (DEPTH, HEAD_DIM), f32),
        "lam_q2": 0.1 * jax.random.normal(ks[14], (DEPTH, HEAD_DIM), f32),
        "lam_k2": 0.1 * jax.random.normal(ks[15], (DEPTH, HEAD_DIM), f32),
        "subln_g": 1.0 + 0.02 * jax.random.normal(ks[16], (DEPTH, V_DIM), f32),
        "w_out": jax.random.normal(ks[17], (DEPTH, D_ATTN + D_LRU, D_MODEL), f32) * (D_ATTN + D_LRU) ** -0.5,
        "final_g": 1.0 + 0.02 * jax.random.normal(ks[18], (D_MODEL,), f32),
    }


def reference(x, meta_tokens, rel_bias, norm_g, w_in, conv_w, conv_b, w_a, b_a, w_x, b_x,
              lru_lambda, lam_q1, lam_k1, lam_q2, lam_k2, subln_g, w_out, final_g):
    B = x.shape[0]
    meta = jnp.broadcast_to(meta_tokens[None].astype(x.dtype), (B, N_META, D_MODEL))
    x = jnp.concatenate([meta, x], axis=1)
    T = x.shape[1]
    dist_bias = rel_bias.astype(jnp.float32)[t5_causal_bucket(jnp.arange(T, dtype=jnp.int32))]
    splits = [D_ATTN, 2 * D_ATTN, 3 * D_ATTN, 4 * D_ATTN, 4 * D_ATTN + D_LRU]

    for l in range(DEPTH):
        lam_init = lambda_init_fn(l)
        h = rmsnorm(x, norm_g[l], NORM_EPS)
        proj = jnp.einsum('btd,de->bte', h, w_in[l])
        q, k, v, g_att, u, g_lru = jnp.split(proj, splits, axis=-1)
        q = q.reshape(B, T, N_HEADS, 2, HEAD_DIM)
        k = k.reshape(B, T, N_HEADS, 2, HEAD_DIM)
        v = v.reshape(B, T, N_HEADS, V_DIM)
        lam = (jnp.exp(jnp.sum(lam_q1[l].astype(jnp.float32) * lam_k1[l].astype(jnp.float32)))
               - jnp.exp(jnp.sum(lam_q2[l].astype(jnp.float32) * lam_k2[l].astype(jnp.float32)))
               + lam_init)
        att = diff_attention(q, k, v, dist_bias, lam)
        att = (rmsnorm(att, subln_g[l], SUBLN_EPS) * (1.0 - lam_init)).reshape(B, T, D_ATTN)
        att = att * jax.nn.silu(g_att)
        rec = rg_lru_branch(u, conv_w[l], conv_b[l], w_a[l], b_a[l], w_x[l], b_x[l], lru_lambda[l])
        rec = rec * jax.nn.silu(g_lru)
        mixed = jnp.concatenate([att, rec], axis=-1)
        x = x + jnp.einsum('bte,ed->btd', mixed, w_out[l])

    return rmsnorm(x, final_g, NORM_EPS)[:, N_META:]
```

```cpp
#include <hip/hip_runtime.h>
#include <cstdio>
#include <cstdint>

typedef unsigned short bf16_t;
typedef short bf16x8 __attribute__((ext_vector_type(8)));
typedef float f32x4 __attribute__((ext_vector_type(4)));

constexpr int BATCH = 2, SEQ = 4096, DM = 2048, NMETA = 16, T = SEQ + NMETA, TP = 4160;
constexpr int NH = 8, HD = 64, VD = 128, DA = 1024, DL = 1024, DIN = 6144;
constexpr int MR = BATCH * SEQ;
constexpr size_t MiB = 1u << 20;
constexpr size_t WS_CTL = 0;
constexpr size_t WS_WINT = 1 * MiB;
constexpr size_t WS_WOUTT = 25 * MiB;
constexpr size_t WS_WGT = 33 * MiB;
constexpr size_t WS_HMETA = 33 * MiB + 512 * 1024;
constexpr size_t WS_BIAST = 33 * MiB + 640 * 1024;
constexpr size_t WS_H = 34 * MiB;
constexpr size_t WS_P = 66 * MiB;
constexpr size_t PSTRIDE = 17 * MiB;
constexpr size_t WS_MIX = 168 * MiB;
constexpr size_t WS_END = 200 * MiB;

__device__ __forceinline__ float bf2f(bf16_t v) { return __uint_as_float((unsigned)v << 16); }
__device__ __forceinline__ bf16_t f2bf(float f) { unsigned u = __float_as_uint(f); return (bf16_t)((u + 0x7fffu + ((u >> 16) & 1u)) >> 16); }
__device__ __forceinline__ float wave_sum(float v) {
#pragma unroll
    for (int o = 1; o < 64; o <<= 1) v += __shfl_xor(v, o);
    return v;
}
__device__ __forceinline__ float wave_max(float v) {
#pragma unroll
    for (int o = 1; o < 64; o <<= 1) v = fmaxf(v, __shfl_xor(v, o));
    return v;
}
__device__ __forceinline__ int t5_bucket(int d) {
    if (d < 16) return d;
    int l = 16 + (int)(logf((float)d / 16.0f) / logf(8.0f) * 16.0f);
    return l < 31 ? l : 31;
}

__global__ __launch_bounds__(256) void n_prologue(const float* __restrict__ x, const float* __restrict__ meta, const float* __restrict__ rel_bias, const float* __restrict__ norm_g,
                                                  const float* __restrict__ w_in, const float* __restrict__ w_a, const float* __restrict__ w_x, const float* __restrict__ w_out,
                                                  unsigned char* ws) {
    bf16_t* WinT = (bf16_t*)(ws + WS_WINT); bf16_t* WoutT = (bf16_t*)(ws + WS_WOUTT); bf16_t* WgT = (bf16_t*)(ws + WS_WGT);
    bf16_t* Hm = (bf16_t*)(ws + WS_HMETA); float* biasT = (float*)(ws + WS_BIAST); bf16_t* H = (bf16_t*)(ws + WS_H);
    const size_t gtid = (size_t)blockIdx.x * 256 + threadIdx.x, gsz = (size_t)gridDim.x * 256;
    for (size_t e = gtid; e < (size_t)DIN * DM; e += gsz) { const int n = (int)(e / DM), k = (int)(e % DM); WinT[e] = f2bf(w_in[(size_t)k * DIN + n]); }
    for (size_t e = gtid; e < (size_t)DM * DM; e += gsz) { const int n = (int)(e / DM), k = (int)(e % DM); WoutT[e] = f2bf(w_out[(size_t)k * DM + n]); }
    for (size_t e = gtid; e < (size_t)2 * 8 * 128 * 128; e += gsz) { const int c = e & 127, d = (e >> 7) & 127, n = (e >> 14) & 7, g = (int)(e >> 17);
        const float* w = g ? w_x : w_a; WgT[e] = f2bf(w[((size_t)n * 128 + c) * 128 + d]); }
    for (size_t e = gtid; e < 8 * 128; e += gsz) { const int d = e & 127, h = (int)(e >> 7); biasT[e] = (rel_bias[t5_bucket(d) * 8 + h] - rel_bias[31 * 8 + h]) * 8.0f; }
    for (size_t e = gtid; e < (size_t)2 * 2 * (TP - T) * 1024; e += gsz) { const int col = e & 1023; const int rr = (int)((e >> 10) % (TP - T)); const int b = (int)((e >> 10) / (TP - T)) & 1; const int which = (int)((e >> 10) / (TP - T)) >> 1;
        bf16_t* P = (bf16_t*)(ws + WS_P + (size_t)(1 + which) * PSTRIDE); P[((size_t)b * TP + T + rr) * 1024 + col] = 0; }
    const int wave = threadIdx.x >> 6, lane = threadIdx.x & 63;
    for (int row = blockIdx.x * 4 + wave; row < MR + NMETA; row += gridDim.x * 4) {
        const float* xr = row < MR ? x + (size_t)row * DM : meta + (size_t)(row - MR) * DM;
        bf16_t* o = row < MR ? H + (size_t)row * DM : Hm + (size_t)(row - MR) * DM;
        float v[32]; float s = 0.f;
#pragma unroll
        for (int j = 0; j < 32; ++j) { v[j] = xr[j * 64 + lane]; s += v[j] * v[j]; }
        const float rs = rsqrtf(wave_sum(s) * (1.0f / DM) + 1e-6f);
#pragma unroll
        for (int j = 0; j < 32; ++j) o[j * 64 + lane] = f2bf(v[j] * rs * norm_g[j * 64 + lane]);
    }
}

__global__ __launch_bounds__(256) void n_gemm1(unsigned char* ws) {
    const bf16_t* H = (const bf16_t*)(ws + WS_H); const bf16_t* Hm = (const bf16_t*)(ws + WS_HMETA); const bf16_t* Bt = (const bf16_t*)(ws + WS_WINT);
    const int wave = threadIdx.x >> 6, lane = threadIdx.x & 63, fr = lane & 15, fq = lane >> 4;
    const int strip = blockIdx.x * 4 + wave;
    const int ms = strip / 96, ns = strip % 96;
    if (ms >= (MR + NMETA) / 16) return;
    const int m0 = ms * 16, n0 = ns * 64;
    const int arow = m0 + fr;
    const bf16_t* ap = (arow < MR ? H + (size_t)arow * DM : Hm + (size_t)(arow - MR) * DM) + 8 * fq;
    const bf16_t* bp = Bt + (size_t)(n0 + fr) * DM + 8 * fq;
    f32x4 acc[4] = {};
    for (int k0 = 0; k0 < DM; k0 += 32) {
        const bf16x8 a = *(const bf16x8*)(ap + k0);
#pragma unroll
        for (int j = 0; j < 4; ++j) { const bf16x8 b = *(const bf16x8*)(bp + (size_t)j * 16 * DM + k0); acc[j] = __builtin_amdgcn_mfma_f32_16x16x32_bf16(b, a, acc[j], 0, 0, 0); }
    }
    const int which = n0 >> 10;
    bf16_t* P = (bf16_t*)(ws + WS_P + (size_t)which * PSTRIDE);
#pragma unroll
    for (int j = 0; j < 4; ++j) {
        const int col = (n0 & 1023) + 16 * j + 4 * fq;
        unsigned lo = f2bf(acc[j][0]) | ((unsigned)f2bf(acc[j][1]) << 16), hi = f2bf(acc[j][2]) | ((unsigned)f2bf(acc[j][3]) << 16);
        if (arow < MR) { const int b = arow >> 12, i = arow & 4095; *(uint2*)(P + ((size_t)b * TP + NMETA + i) * 1024 + col) = make_uint2(lo, hi); }
        else { const int p = arow - MR; *(uint2*)(P + (size_t)p * 1024 + col) = make_uint2(lo, hi); *(uint2*)(P + ((size_t)TP + p) * 1024 + col) = make_uint2(lo, hi); }
    }
}

__global__ __launch_bounds__(256) void n_attn(unsigned char* ws, const float* __restrict__ lq1, const float* __restrict__ lk1, const float* __restrict__ lq2, const float* __restrict__ lk2,
                                              const float* __restrict__ subln_g) {
    __shared__ float qs[4][128];
    const bf16_t* Q = (const bf16_t*)(ws + WS_P); const bf16_t* K = (const bf16_t*)(ws + WS_P + PSTRIDE); const bf16_t* V = (const bf16_t*)(ws + WS_P + 2 * PSTRIDE);
    const bf16_t* GA = (const bf16_t*)(ws + WS_P + 3 * PSTRIDE); const float* biasT = (const float*)(ws + WS_BIAST); bf16_t* MIX = (bf16_t*)(ws + WS_MIX);
    const int wave = threadIdx.x >> 6, lane = threadIdx.x & 63;
    const int item = blockIdx.x * 4 + wave; const int h = item & 7, r = item >> 3, b = r >> 12, i = r & 4095, p = NMETA + i;
    const size_t prow = (size_t)b * TP + p;
    qs[wave][lane] = bf2f(Q[prow * 1024 + h * 128 + lane]); qs[wave][64 + lane] = bf2f(Q[prow * 1024 + h * 128 + 64 + lane]);
    __syncthreads();
    const float lam = expf(wave_sum(lq1[lane] * lk1[lane])) - expf(wave_sum(lq2[lane] * lk2[lane])) + 0.2f;
    const int nk = p + 1;
    const float* bt = biasT + h * 128;
    float m1 = -1e30f, m2 = -1e30f;
    for (int pass = 0; pass < 1; ++pass) {
        for (int k0 = 0; k0 < nk; k0 += 64) { const int j = k0 + lane;
            if (j < nk) { const bf16_t* kr = K + ((size_t)b * TP + j) * 1024 + h * 128; float s1 = 0.f, s2 = 0.f;
                for (int c = 0; c < 8; ++c) { const bf16x8 a = *(const bf16x8*)(kr + c * 8), bb = *(const bf16x8*)(kr + 64 + c * 8);
#pragma unroll
                    for (int e = 0; e < 8; ++e) { s1 += qs[wave][c * 8 + e] * bf2f((bf16_t)a[e]); s2 += qs[wave][64 + c * 8 + e] * bf2f((bf16_t)bb[e]); } }
                const int d = p - j; const float bi = bt[d < 127 ? d : 127];
                s1 = (s1 + bi) * 0.125f; s2 = (s2 + bi) * 0.125f; m1 = fmaxf(m1, s1); m2 = fmaxf(m2, s2); } }
    }
    m1 = wave_max(m1); m2 = wave_max(m2);
    float l1 = 0.f, l2 = 0.f, o1a = 0.f, o1b = 0.f, o2a = 0.f, o2b = 0.f;
    for (int k0 = 0; k0 < nk; k0 += 64) { const int j = k0 + lane; float p1 = 0.f, p2 = 0.f;
        if (j < nk) { const bf16_t* kr = K + ((size_t)b * TP + j) * 1024 + h * 128; float s1 = 0.f, s2 = 0.f;
            for (int c = 0; c < 8; ++c) { const bf16x8 a = *(const bf16x8*)(kr + c * 8), bb = *(const bf16x8*)(kr + 64 + c * 8);
#pragma unroll
                for (int e = 0; e < 8; ++e) { s1 += qs[wave][c * 8 + e] * bf2f((bf16_t)a[e]); s2 += qs[wave][64 + c * 8 + e] * bf2f((bf16_t)bb[e]); } }
            const int d = p - j; const float bi = bt[d < 127 ? d : 127];
            s1 = (s1 + bi) * 0.125f; s2 = (s2 + bi) * 0.125f; p1 = expf(s1 - m1); p2 = expf(s2 - m2); }
        l1 += p1; l2 += p2;
        const int cnt = (nk - k0) < 64 ? (nk - k0) : 64;
        for (int jj = 0; jj < cnt; ++jj) { const float a = __shfl(p1, jj), c = __shfl(p2, jj);
            const unsigned vv = *(const unsigned*)(V + ((size_t)b * TP + k0 + jj) * 1024 + h * 128 + 2 * lane);
            const float v0 = bf2f((bf16_t)(vv & 0xffffu)), v1 = bf2f((bf16_t)(vv >> 16));
            o1a += a * v0; o1b += a * v1; o2a += c * v0; o2b += c * v1; } }
    l1 = wave_sum(l1); l2 = wave_sum(l2);
    const float oa = o1a / l1 - lam * o2a / l2, ob = o1b / l1 - lam * o2b / l2;
    const float rs = rsqrtf(wave_sum(oa * oa + ob * ob) * (1.0f / 128.0f) + 1e-5f);
    const float ga = bf2f(GA[prow * 1024 + h * 128 + 2 * lane]), gb = bf2f(GA[prow * 1024 + h * 128 + 2 * lane + 1]);
    const float ya = oa * rs * subln_g[2 * lane] * 0.8f * (ga / (1.0f + expf(-ga))), yb = ob * rs * subln_g[2 * lane + 1] * 0.8f * (gb / (1.0f + expf(-gb)));
    *(unsigned*)(MIX + (size_t)r * 2048 + h * 128 + 2 * lane) = f2bf(ya) | ((unsigned)f2bf(yb) << 16);
}

__global__ __launch_bounds__(128) void n_lru(unsigned char* ws, const float* __restrict__ conv_w, const float* __restrict__ conv_b, const float* __restrict__ w_a, const float* __restrict__ b_a,
                                             const float* __restrict__ w_x, const float* __restrict__ b_x, const float* __restrict__ lru_lambda) {
    extern __shared__ float wl[];
    float* ucs = wl + 128 * 256;
    const bf16_t* U = (const bf16_t*)(ws + WS_P + 4 * PSTRIDE); const bf16_t* GL = (const bf16_t*)(ws + WS_P + 5 * PSTRIDE); bf16_t* MIX = (bf16_t*)(ws + WS_MIX);
    const int b = blockIdx.x >> 3, n = blockIdx.x & 7, d = threadIdx.x, c = n * 128 + d;
    for (int cc = 0; cc < 128; ++cc) { wl[cc * 256 + d] = w_a[((size_t)n * 128 + cc) * 128 + d]; wl[cc * 256 + 128 + d] = w_x[((size_t)n * 128 + cc) * 128 + d]; }
    const float cw0 = conv_w[c], cw1 = conv_w[1024 + c], cw2 = conv_w[2048 + c], cw3 = conv_w[3072 + c], cb = conv_b[c], ba = b_a[c], bx = b_x[c];
    const float lmb = lru_lambda[c]; const float sp = log1pf(expf(-lmb));
    float um3 = 0.f, um2 = 0.f, um1 = 0.f, h = 0.f;
    for (int t = 0; t < T; ++t) {
        const float u0 = bf2f(U[((size_t)b * TP + t) * 1024 + c]);
        const float uc = cw0 * um3 + cw1 * um2 + cw2 * um1 + cw3 * u0 + cb;
        um3 = um2; um2 = um1; um1 = u0;
        __syncthreads(); ucs[d] = uc; __syncthreads();
        float pa = ba, px = bx;
        for (int cc = 0; cc < 128; ++cc) { const float v = ucs[cc]; pa += v * wl[cc * 256 + d]; px += v * wl[cc * 256 + 128 + d]; }
        const float r = 1.0f / (1.0f + expf(-pa)), ig = 1.0f / (1.0f + expf(-px));
        const float log_a = -8.0f * r * sp; const float a = expf(log_a); float mult = sqrtf(-expm1f(2.0f * log_a)); if (t == 0) mult = 1.0f;
        h = a * h + mult * ig * uc;
        if (t >= NMETA) { const float g = bf2f(GL[((size_t)b * TP + t) * 1024 + c]); MIX[((size_t)b * SEQ + t - NMETA) * 2048 + 1024 + c] = f2bf(h * (g / (1.0f + expf(-g)))); }
    }
}

__global__ __launch_bounds__(256) void n_gemm2(unsigned char* ws, const float* __restrict__ x, float* __restrict__ out) {
    const bf16_t* A = (const bf16_t*)(ws + WS_MIX); const bf16_t* Bt = (const bf16_t*)(ws + WS_WOUTT);
    const int wave = threadIdx.x >> 6, lane = threadIdx.x & 63, fr = lane & 15, fq = lane >> 4;
    const int strip = blockIdx.x * 4 + wave; const int ms = strip / 32, ns = strip % 32;
    const int m0 = ms * 16, n0 = ns * 64;
    const bf16_t* ap = A + (size_t)(m0 + fr) * DM + 8 * fq; const bf16_t* bp = Bt + (size_t)(n0 + fr) * DM + 8 * fq;
    f32x4 acc[4] = {};
    for (int k0 = 0; k0 < DM; k0 += 32) {
        const bf16x8 a = *(const bf16x8*)(ap + k0);
#pragma unroll
        for (int j = 0; j < 4; ++j) { const bf16x8 b = *(const bf16x8*)(bp + (size_t)j * 16 * DM + k0); acc[j] = __builtin_amdgcn_mfma_f32_16x16x32_bf16(b, a, acc[j], 0, 0, 0); }
    }
#pragma unroll
    for (int j = 0; j < 4; ++j) { const size_t o = (size_t)(m0 + fr) * DM + n0 + 16 * j + 4 * fq; const f32x4 xv = *(const f32x4*)(x + o); *(f32x4*)(out + o) = xv + acc[j]; }
}
__global__ __launch_bounds__(256) void n_final(float* __restrict__ out, const float* __restrict__ final_g) {
    const int wave = threadIdx.x >> 6, lane = threadIdx.x & 63; const int row = blockIdx.x * 4 + wave;
    float* o = out + (size_t)row * DM; float v[32]; float s = 0.f;
#pragma unroll
    for (int j = 0; j < 32; ++j) { v[j] = o[j * 64 + lane]; s += v[j] * v[j]; }
    const float rs = rsqrtf(wave_sum(s) * (1.0f / DM) + 1e-6f);
#pragma unroll
    for (int j = 0; j < 32; ++j) o[j * 64 + lane] = v[j] * rs * final_g[j * 64 + lane];
}

extern "C" void kernel_launch(void* const* d_in, const int* in_sizes, int n_in, void* d_out, int out_size, void* d_ws, size_t ws_size, hipStream_t stream) {
    if (n_in != 19 || in_sizes[0] != MR * DM || out_size != MR * DM || ws_size < WS_END) { fprintf(stderr, "kernel_launch: unexpected shapes (n_in %d in0 %d out %d ws %zu)\n", n_in, n_in > 0 ? in_sizes[0] : -1, out_size, ws_size); return; }
    const float* x = (const float*)d_in[0]; const float* meta = (const float*)d_in[1]; const float* rel_bias = (const float*)d_in[2]; const float* norm_g = (const float*)d_in[3];
    const float* w_in = (const float*)d_in[4]; const float* conv_w = (const float*)d_in[5]; const float* conv_b = (const float*)d_in[6]; const float* w_a = (const float*)d_in[7];
    const float* b_a = (const float*)d_in[8]; const float* w_x = (const float*)d_in[9]; const float* b_x = (const float*)d_in[10]; const float* lru_lambda = (const float*)d_in[11];
    const float* lq1 = (const float*)d_in[12]; const float* lk1 = (const float*)d_in[13]; const float* lq2 = (const float*)d_in[14]; const float* lk2 = (const float*)d_in[15];
    const float* subln_g = (const float*)d_in[16]; const float* w_out = (const float*)d_in[17]; const float* final_g = (const float*)d_in[18];
    unsigned char* ws = (unsigned char*)d_ws; float* out = (float*)d_out;
    static bool attr = false;
    if (!attr) { attr = true; (void)hipFuncSetAttribute((const void*)n_lru, hipFuncAttributeMaxDynamicSharedMemorySize, (128 * 256 + 128) * 4); }
    n_prologue<<<2048, 256, 0, stream>>>(x, meta, rel_bias, norm_g, w_in, w_a, w_x, w_out, ws);
    n_gemm1<<<(513 * 96 + 3) / 4, 256, 0, stream>>>(ws);
    n_attn<<<MR * NH / 4, 256, 0, stream>>>(ws, lq1, lk1, lq2, lk2, subln_g);
    n_lru<<<16, 128, (128 * 256 + 128) * 4, stream>>>(ws, conv_w, conv_b, w_a, b_a, w_x, b_x, lru_lambda);
    n_gemm2<<<512 * 32 / 4, 256, 0, stream>>>(ws, x, out);
    n_final<<<MR / 4, 256, 0, stream>>>(out, final_g);
}
```
